# Optimizing an MI355X kernel written in HIP

```python
import jax, jax.numpy as jnp
from jax import lax
import numpy as np

D_MODEL = 1024
BATCH = 8
SEQ = 2048
DEPTH = 4
DEC_BATCH = 128
DEC_SEQ = 8
PAST_LEN = 16384
PAGE_SIZE = 128

N_MIXERS = 2
N_CONV_LAYERS = (DEPTH + 1) // 2
N_SGU_LAYERS = DEPTH // 2
D_CONV = D_MODEL
CONV_W = 3
D_SGU = 3 * D_MODEL
N_SGU_HEADS = 8
CHUNK = 128
D_FF = 2816
ALPHA = (2.0 * DEPTH) ** 0.25
BETA = (8.0 * DEPTH) ** -0.25
LN_EPS = 1e-5

kernel_name = 'hybrid_shortconv_chunkgmlp_macaron_deepnorm_step'


def layer_norm(x, g, b):
    xf = x.astype(jnp.float32)
    mu = jnp.mean(xf, axis=-1, keepdims=True)
    var = jnp.mean(jnp.square(xf - mu), axis=-1, keepdims=True)
    return ((xf - mu) * lax.rsqrt(var + LN_EPS) * g.astype(jnp.float32) + b.astype(jnp.float32)).astype(x.dtype)


def post_norm(x, sub, g, b):
    return layer_norm(ALPHA * x + sub, g, b)


def swiglu(x, w_in, w_out):
    gate, up = jnp.split(x @ w_in, 2, axis=-1)
    return (jax.nn.silu(gate) * up) @ w_out


def conv_mixer(x, buf, w_in, w_conv, w_out):
    b_gate, c_gate, h = jnp.split(x @ w_in, 3, axis=-1)
    g = c_gate * h
    gp = jnp.concatenate([buf.astype(g.dtype), g], axis=1)
    conv = lax.conv_general_dilated(
        gp, w_conv[:, None, :].astype(g.dtype), window_strides=(1,), padding='VALID',
        dimension_numbers=('NWC', 'WIO', 'NWC'), feature_group_count=D_CONV)
    y = (b_gate * conv) @ w_out
    return y, gp[:, -(CONV_W - 1):, :]


def chunk_mix(v, w_s, b_s):
    n, L, dv = v.shape
    lc = L if L < CHUNK else CHUNK
    n_chunks = -(-L // lc)
    pad = n_chunks * lc - L
    vp = jnp.pad(v, ((0, 0), (0, pad), (0, 0))) if pad else v
    vc = vp.reshape(n, n_chunks, lc, N_SGU_HEADS, dv // N_SGU_HEADS)
    ws = jnp.tril(w_s[:, :lc, :lc]).astype(v.dtype)
    bs = jnp.transpose(b_s[:, :lc]).astype(v.dtype)
    out = jnp.einsum('hts,bcshd->bcthd', ws, vc) + bs[:, :, None]
    return out.reshape(n, n_chunks * lc, dv)[:, :L, :]


def sgu_mixer(x, w_in, ln_g, ln_b, w_s, b_s, w_out):
    z = jax.nn.gelu(x @ w_in, approximate=False)
    u, v = jnp.split(z, 2, axis=-1)
    v = layer_norm(v, ln_g, ln_b)
    y = (u * chunk_mix(v, w_s, b_s)) @ w_out
    return y, v


def setup_inputs(seed: int = 0) -> dict:
    key = jax.random.key(seed)
    ks = jax.random.split(key, 18)

    def nrm(k, shape, scale):
        return jax.random.normal(k, shape, jnp.float32) * scale

    return {
        'x_prompt': nrm(ks[0], (BATCH, SEQ, D_MODEL), 1.0),
        'x_sample': nrm(ks[1], (DEC_BATCH, DEC_SEQ, D_MODEL), 1.0),
        'cache_conv': nrm(ks[2], (N_CONV_LAYERS, DEC_BATCH, CONV_W - 1, D_CONV), 1.0),
        'ln_g': 1.0 + nrm(ks[3], (DEPTH, 3, D_MODEL), 0.02),
        'ln_b': nrm(ks[4], (DEPTH, 3, D_MODEL), 0.02),
        'ffn1_w_in': nrm(ks[5], (DEPTH, D_MODEL, 2 * D_FF), D_MODEL ** -0.5),
        'ffn1_w_out': nrm(ks[6], (DEPTH, D_FF, D_MODEL), BETA * D_FF ** -0.5),
        'ffn2_w_in': nrm(ks[7], (DEPTH, D_MODEL, 2 * D_FF), D_MODEL ** -0.5),
        'ffn2_w_out': nrm(ks[8], (DEPTH, D_FF, D_MODEL), BETA * D_FF ** -0.5),
        'conv_w_in': nrm(ks[9], (N_CONV_LAYERS, D_MODEL, 3 * D_CONV), D_MODEL ** -0.5),
        'conv_w': nrm(ks[10], (N_CONV_LAYERS, CONV_W, D_CONV), CONV_W ** -0.5),
        'conv_w_out': nrm(ks[11], (N_CONV_LAYERS, D_CONV, D_MODEL), BETA * D_CONV ** -0.5),
        'sgu_w_in': nrm(ks[12], (N_SGU_LAYERS, D_MODEL, 2 * D_SGU), D_MODEL ** -0.5),
        'sgu_ln_g': 1.0 + nrm(ks[13], (N_SGU_LAYERS, D_SGU), 0.02),
        'sgu_ln_b': nrm(ks[14], (N_SGU_LAYERS, D_SGU), 0.02),
        'sgu_w_s': nrm(ks[15], (N_SGU_LAYERS, N_SGU_HEADS, CHUNK, CHUNK), CHUNK ** -0.5),
        'sgu_b_s': 1.0 + nrm(ks[16], (N_SGU_LAYERS, N_SGU_HEADS, CHUNK), 0.02),
        'sgu_w_out': nrm(ks[17], (N_SGU_LAYERS, D_SGU, D_MODEL), BETA * D_SGU ** -0.5),
    }


def reference(x_prompt, x_sample, cache_conv, ln_g, ln_b, ffn1_w_in, ffn1_w_out, ffn2_w_in, ffn2_w_out,
              conv_w_in, conv_w, conv_w_out, sgu_w_in, sgu_ln_g, sgu_ln_b, sgu_w_s, sgu_b_s, sgu_w_out):
    xp, xs = x_prompt, x_sample
    conv_p, conv_s, sgu_s = [], [], []
    for i in range(DEPTH):
        j = i // N_MIXERS
        xp = post_norm(xp, 0.5 * swiglu(xp, ffn1_w_in[i], ffn1_w_out[i]), ln_g[i, 0], ln_b[i, 0])
        xs = post_norm(xs, 0.5 * swiglu(xs, ffn1_w_in[i], ffn1_w_out[i]), ln_g[i, 0], ln_b[i, 0])
        if i % N_MIXERS == 0:
            zero_buf = jnp.zeros((xp.shape[0], CONV_W - 1, D_CONV), xp.dtype)
            yp, bp = conv_mixer(xp, zero_buf, conv_w_in[j], conv_w[j], conv_w_out[j])
            ys, bs = conv_mixer(xs, cache_conv[j], conv_w_in[j], conv_w[j], conv_w_out[j])
            conv_p.append(bp)
            conv_s.append(bs)
        else:
            yp, _ = sgu_mixer(xp, sgu_w_in[j], sgu_ln_g[j], sgu_ln_b[j], sgu_w_s[j], sgu_b_s[j], sgu_w_out[j])
            ys, vs = sgu_mixer(xs, sgu_w_in[j], sgu_ln_g[j], sgu_ln_b[j], sgu_w_s[j], sgu_b_s[j], sgu_w_out[j])
            sgu_s.append(vs)
        xp = post_norm(xp, yp, ln_g[i, 1], ln_b[i, 1])
        xs = post_norm(xs, ys, ln_g[i, 1], ln_b[i, 1])
        xp = post_norm(xp, 0.5 * swiglu(xp, ffn2_w_in[i], ffn2_w_out[i]), ln_g[i, 2], ln_b[i, 2])
        xs = post_norm(xs, 0.5 * swiglu(xs, ffn2_w_in[i], ffn2_w_out[i]), ln_g[i, 2], ln_b[i, 2])
    return (xp, xs, jnp.stack(conv_p), jnp.stack(conv_s), jnp.stack(sgu_s))
```

```cpp
#include <hip/hip_runtime.h>
#include <hip/hip_cooperative_groups.h>
#include <cstdio>
#include <cstdint>
namespace cg = cooperative_groups;
namespace pg8 {
#define PG8_LAS __attribute__((address_space(3)))
typedef unsigned short bf16_t;
typedef short bf16x8 __attribute__((ext_vector_type(8)));
typedef float f32x4 __attribute__((ext_vector_type(4)));
typedef unsigned u32x4 __attribute__((ext_vector_type(4)));
constexpr int BM = 256, BK = 64, HALF = 128, HTB = HALF * BK * 2  , STAGE_BYTES = 8 * HTB, NXCD = 8, WGM = 8;

__host__ __device__ __forceinline__ int lds_byte(int r, int c) { const int st = (r >> 4) * 2 + (c >> 5), rr = r & 15, cc = c & 31, ob = rr * 64 + cc * 2; return st * 1024 + (ob ^ (((ob >> 9) & 1) << 5)); }
__host__ __device__ __forceinline__ void stage_rc(int b, int& R, int& C) { const int st = b / 1024, sb = b % 1024, swz = sb ^ (((sb >> 9) & 1) << 5); R = (st >> 1) * 16 + swz / 64; C = (st & 1) * 32 + (swz % 64) / 2; }
__host__ __device__ __forceinline__ int perm32(int rho) { const int n = rho >> 4, i = rho & 15; return 8 * (i >> 2) + 4 * n + (i & 3); }

struct Unit { int pm, pn; };
struct Gemm { const bf16_t* A; const bf16_t* Bt; int M, N, K; };

struct StaticOrder {
    int nM, nN, nwg, G, c;
    __host__ __device__ void init(int M, int N, int G_, int c_) { nM = M / BM; nN = N / BM; nwg = nM * nN; G = G_; c = c_; }
    __host__ __device__ bool next(int i, Unit& u) const {
        const long L = (long)i * G + c; if (L >= nwg) return false;
        int wgid = (int)L; { const int q = nwg / NXCD, r = nwg % NXCD, xcd = wgid % NXCD, off = wgid / NXCD; wgid = (xcd < r ? xcd * (q + 1) : r * (q + 1) + (xcd - r) * q) + off; }
        const int nig = WGM * nN, gid = wgid / nig, fm = gid * WGM, gsz = (nM - fm) < WGM ? (nM - fm) : WGM;
        u.pm = fm + ((wgid % nig) % gsz); u.pn = (wgid % nig) / gsz; return true;
    }
    __device__ __forceinline__ void a_ready(const Unit&) const {}
    __device__ __forceinline__ void done(const Unit&) const {}
};

__device__ __forceinline__ unsigned cvt_pk_bf16(float lo, float hi) { unsigned r; asm volatile("v_cvt_pk_bf16_f32 %0, %1, %2" : "=v"(r) : "v"(lo), "v"(hi)); return r; }
typedef float f32x2 __attribute__((ext_vector_type(2)));
__device__ __forceinline__ f32x2 gelu_pk(f32x2 v) {
    const f32x2 av = __builtin_elementwise_abs(v), d = av * 0.2316418882f + 1.0f;
    f32x2 t; t.x = __builtin_amdgcn_rcpf(d.x); t.y = __builtin_amdgcn_rcpf(d.y);
    f32x2 q = t * 0.5307027145f + (-0.7265760135f); q = q * t + 0.7107068705f; q = q * t + (-0.142248368f); q = q * t + 0.127414796f; q = q * t;
    const f32x2 s = (v * v) * (-0.72134752044f);
    f32x2 e; e.x = __builtin_amdgcn_exp2f(s.x); e.y = __builtin_amdgcn_exp2f(s.y);
    const f32x2 m = v * (q * e), r = v - m;
    f32x2 o; o.x = v.x < 0.f ? m.x : r.x; o.y = v.y < 0.f ? m.y : r.y; return o;
}
__device__ __forceinline__ float silu_f(float x) { const float e = __builtin_amdgcn_exp2f(x * -1.4426950408889634f); return x * __builtin_amdgcn_rcpf(1.0f + e); }


struct EpiSwiGLU {
    static constexpr bool PERM = true, AFTER_DRAIN = false;
    bf16_t* H; int ldh;
    __device__ __forceinline__ void operator()(const f32x4 (&acc)[2][2][4][2], const Unit& u, int wr, int wc, int fr, int fq) const {
        const int row0 = u.pm * BM + wr * 64 + fr, col0 = u.pn * HALF + wc * 32 + 8 * fq;
#pragma unroll
        for (int ai = 0; ai < 2; ++ai)
#pragma unroll
            for (int m = 0; m < 4; ++m) { bf16_t* rowp = H + (size_t)(row0 + ai * HALF + m * 16) * ldh + col0;
                const f32x4 g0 = acc[ai][0][m][0], g1 = acc[ai][0][m][1], u0 = acc[ai][1][m][0], u1 = acc[ai][1][m][1];
                u32x4 w; w.x = cvt_pk_bf16(silu_f(g0[0]) * u0[0], silu_f(g0[1]) * u0[1]); w.y = cvt_pk_bf16(silu_f(g0[2]) * u0[2], silu_f(g0[3]) * u0[3]);
                w.z = cvt_pk_bf16(silu_f(g1[0]) * u1[0], silu_f(g1[1]) * u1[1]); w.w = cvt_pk_bf16(silu_f(g1[2]) * u1[2], silu_f(g1[3]) * u1[3]);
                *(u32x4*)rowp = w; }
    }
};
struct EpiResid {
    static constexpr bool PERM = false, AFTER_DRAIN = false;
    float* X; int ldc; float alpha, s;
    __device__ __forceinline__ void operator()(const f32x4 (&acc)[2][2][4][2], const Unit& u, int wr, int wc, int fr, int fq) const {
        const int row0 = u.pm * BM + wr * 64 + fr, col0 = u.pn * BM + wc * 32 + 4 * fq;
#pragma unroll
        for (int ai = 0; ai < 2; ++ai)
#pragma unroll
            for (int m = 0; m < 4; ++m) { float* rowp = X + (size_t)(row0 + ai * HALF + m * 16) * ldc + col0;
                f32x4 xv[2][2];
#pragma unroll
                for (int bj = 0; bj < 2; ++bj)
#pragma unroll
                    for (int n = 0; n < 2; ++n) xv[bj][n] = *(const f32x4*)(rowp + bj * HALF + n * 16);
#pragma unroll
                for (int bj = 0; bj < 2; ++bj)
#pragma unroll
                    for (int n = 0; n < 2; ++n) *(f32x4*)(rowp + bj * HALF + n * 16) = xv[bj][n] * alpha + acc[ai][bj][m][n] * s;
                if (m & 1) asm volatile("" ::: "memory"); }
    }
};
struct EpiConvIn {
    static constexpr bool PERM = true, AFTER_DRAIN = false;
    bf16_t* G0; bf16_t* Bg; float* scp; float* scs;
    __device__ __forceinline__ void operator()(const f32x4 (&acc)[2][2][4][2], const Unit& u, int wr, int wc, int fr, int fq) const {
        const int row0 = u.pm * BM + wr * 64 + fr;
        if (u.pn < 8) {
            const int col0 = u.pn * HALF + wc * 32 + 8 * fq;
#pragma unroll
            for (int ai = 0; ai < 2; ++ai)
#pragma unroll
                for (int m = 0; m < 4; ++m) { const int row = row0 + ai * HALF + m * 16;
                    const f32x4 v0 = acc[ai][0][m][0] * acc[ai][1][m][0], v1 = acc[ai][0][m][1] * acc[ai][1][m][1];
                    u32x4 w; w.x = cvt_pk_bf16(v0[0], v0[1]); w.y = cvt_pk_bf16(v0[2], v0[3]); w.z = cvt_pk_bf16(v1[0], v1[1]); w.w = cvt_pk_bf16(v1[2], v1[3]);
                    *(u32x4*)(G0 + (size_t)row * 1024 + col0) = w;
                    float* sp = nullptr;
                    if (row < 16384) { const int t = row & 2047; if (t >= 2046) sp = scp + (size_t)((row >> 11) * 2 + (t - 2046)) * 1024 + col0; }
                    else { const int rs = row - 16384, t = rs & 7; if (t >= 6) sp = scs + (size_t)((rs >> 3) * 2 + (t - 6)) * 1024 + col0; }
                    if (sp) { *(f32x4*)sp = v0; *(f32x4*)(sp + 4) = v1; } }
        } else {
            const int col0 = (u.pn - 8) * BM + wc * 32 + 8 * fq;
#pragma unroll
            for (int ai = 0; ai < 2; ++ai)
#pragma unroll
                for (int m = 0; m < 4; ++m) { bf16_t* rowp = Bg + (size_t)(row0 + ai * HALF + m * 16) * 1024 + col0;
#pragma unroll
                    for (int bj = 0; bj < 2; ++bj) { const f32x4 v0 = acc[ai][bj][m][0], v1 = acc[ai][bj][m][1];
                        u32x4 w; w.x = cvt_pk_bf16(v0[0], v0[1]); w.y = cvt_pk_bf16(v0[2], v0[3]); w.z = cvt_pk_bf16(v1[0], v1[1]); w.w = cvt_pk_bf16(v1[2], v1[3]);
                        *(u32x4*)(rowp + bj * HALF) = w; } }
        }
    }
};
struct EpiSguIn {
    static constexpr bool PERM = true, AFTER_DRAIN = false;
    bf16_t* U; bf16_t* V; float* stats;
    __device__ __forceinline__ void operator()(const f32x4 (&acc)[2][2][4][2], const Unit& u, int wr, int wc, int fr, int fq) const {
        const int row0 = u.pm * BM + wr * 64 + fr; const bool isv = u.pn >= 12;
        bf16_t* base = isv ? V : U; const int col0 = (isv ? u.pn - 12 : u.pn) * BM + wc * 32 + 8 * fq;
#pragma unroll
        for (int ai = 0; ai < 2; ++ai)
#pragma unroll
            for (int m = 0; m < 4; ++m) { const int row = row0 + ai * HALF + m * 16; bf16_t* rowp = base + (size_t)row * 3072 + col0; float s = 0.f, q = 0.f;
#pragma unroll
                for (int bj = 0; bj < 2; ++bj) { f32x4 v0 = acc[ai][bj][m][0], v1 = acc[ai][bj][m][1];
                    { f32x2 a = gelu_pk((f32x2){v0[0], v0[1]}), b = gelu_pk((f32x2){v0[2], v0[3]}), c = gelu_pk((f32x2){v1[0], v1[1]}), d = gelu_pk((f32x2){v1[2], v1[3]});
                      v0 = (f32x4){a.x, a.y, b.x, b.y}; v1 = (f32x4){c.x, c.y, d.x, d.y}; }
                    u32x4 w; w.x = cvt_pk_bf16(v0[0], v0[1]); w.y = cvt_pk_bf16(v0[2], v0[3]); w.z = cvt_pk_bf16(v1[0], v1[1]); w.w = cvt_pk_bf16(v1[2], v1[3]);
                    *(u32x4*)(rowp + bj * HALF) = w;
                    if (isv) {
                        const unsigned ww[4] = {w.x, w.y, w.z, w.w};
#pragma unroll
                        for (int e = 0; e < 4; ++e) { const float lo = __uint_as_float(ww[e] << 16), hi = __uint_as_float(ww[e] & 0xffff0000u); s += lo + hi; q += lo * lo + hi * hi; } } }
                if (isv) { s += __shfl_xor(s, 16); s += __shfl_xor(s, 32); q += __shfl_xor(q, 16); q += __shfl_xor(q, 32);
                    if (fq == 0) { __hip_atomic_fetch_add(stats + 2 * row, s, __ATOMIC_RELAXED, __HIP_MEMORY_SCOPE_AGENT); __hip_atomic_fetch_add(stats + 2 * row + 1, q, __ATOMIC_RELAXED, __HIP_MEMORY_SCOPE_AGENT); } } }
    }
};
template <class Epi, class Sched, bool ALIGN_EPI = false, bool SP2 = false>
__device__ __forceinline__ void gemm_phase(PG8_LAS unsigned char* lds, const Gemm g, const Sched& S, const Epi& E) {
    int tid_ = threadIdx.x; asm volatile("" : "+v"(tid_));
    const int tid = tid_, wid = __builtin_amdgcn_readfirstlane(tid >> 6), lane = tid & 63, wr = wid >> 2, wc = wid & 3, fr = lane & 15, fq = lane >> 4;
    const int K = g.K, nt = K / BK;
    unsigned voffA[2], voffB[2];
#pragma unroll
    for (int i = 0; i < 2; ++i) { int R, C; stage_rc(tid * 16 + i * 8192, R, C); const int Rb = Epi::PERM ? ((R & ~31) + perm32(R & 31)) : R;
        voffA[i] = (unsigned)(R * K + C) * 2u; voffB[i] = (unsigned)(Rb * K + C) * 2u; }
    const size_t kstep = (size_t)(BK * 2);
    const size_t hstep = (size_t)HALF * K * 2;
    const size_t tstep = 2 * hstep;
    const unsigned ldsw = (unsigned)wid * 1024u;
    const int aoff = lds_byte(wr * 64 + fr, fq * 8), boff = lds_byte(wc * 32 + fr, fq * 8);
#define PG8_SA(b, h) (((b) * 2 + (h)) * HTB)
#define PG8_SB(b, h) ((4 + (b) * 2 + (h)) * HTB)
#define PG8_STAGE(bufoff, gbase, voff) do { _Pragma("unroll") for (int _i = 0; _i < 2; ++_i) \
        __builtin_amdgcn_global_load_lds((const unsigned*)((const char*)(gbase) + (voff)[_i]), (PG8_LAS unsigned*)(lds + (bufoff) + ldsw + _i * 8192), 16, 0, 0); } while (0)
#define PG8_LDA(dst, b, h) do { _Pragma("unroll") for (int m = 0; m < 4; ++m) _Pragma("unroll") for (int k = 0; k < 2; ++k) dst[m][k] = *(const PG8_LAS bf16x8*)(lds + PG8_SA(b, h) + aoff + m * 2048 + k * 1024); } while (0)
#define PG8_LDB(dst, b, h) do { _Pragma("unroll") for (int n = 0; n < 2; ++n) _Pragma("unroll") for (int k = 0; k < 2; ++k) dst[n][k] = *(const PG8_LAS bf16x8*)(lds + PG8_SB(b, h) + boff + n * 2048 + k * 1024); } while (0)
#define PG8_MMA(ai, bj, At, Bt) do { __builtin_amdgcn_s_setprio(1); _Pragma("unroll") for (int m = 0; m < 4; ++m) _Pragma("unroll") for (int n = 0; n < 2; ++n) _Pragma("unroll") for (int k = 0; k < 2; ++k) \
        acc[ai][bj][m][n] = __builtin_amdgcn_mfma_f32_16x16x32_bf16(Bt[n][k], At[m][k], acc[ai][bj][m][n], 0, 0, 0); __builtin_amdgcn_s_setprio(0); } while (0)
#define PG8_WAIT_V(n) asm volatile("s_waitcnt vmcnt(" #n ")" ::: "memory")
#define PG8_WAIT_L(n) asm volatile("s_waitcnt lgkmcnt(" #n ")" ::: "memory")
#define PG8_BAR __builtin_amdgcn_s_barrier()
#define PG8_SCHED __builtin_amdgcn_sched_barrier(0)
    Unit cur, nxt; int ui = 0;
    if (!S.next(0, cur)) return;
    f32x4 acc[2][2][4][2];
#pragma unroll
    for (int a = 0; a < 2; ++a)
#pragma unroll
        for (int b = 0; b < 2; ++b)
#pragma unroll
            for (int m = 0; m < 4; ++m)
#pragma unroll
                for (int n = 0; n < 2; ++n) acc[a][b][m][n] = (f32x4){0.f, 0.f, 0.f, 0.f};
    bf16x8 At[4][2], B0[2][2], B1[2][2];
    const char* cA = (const char*)g.A + (size_t)cur.pm * tstep; const char* cB = (const char*)g.Bt + (size_t)cur.pn * tstep;
    S.a_ready(cur);
    if constexpr (SP2) {
        PG8_STAGE(PG8_SB(0, 0), cB, voffB); PG8_STAGE(PG8_SB(0, 1), cB + hstep, voffB); PG8_STAGE(PG8_SA(0, 0), cA, voffA); PG8_STAGE(PG8_SA(0, 1), cA + hstep, voffA);
        if (wr == 1) PG8_BAR;
        PG8_WAIT_V(2); PG8_BAR;
        PG8_STAGE(PG8_SB(1, 0), cB + kstep, voffB); PG8_STAGE(PG8_SA(1, 0), cA + kstep, voffA); PG8_STAGE(PG8_SB(1, 1), cB + hstep + kstep, voffB);
        PG8_WAIT_V(6); PG8_BAR;
    } else {
        PG8_STAGE(PG8_SB(0, 0), cB, voffB); PG8_STAGE(PG8_SA(0, 0), cA, voffA); PG8_STAGE(PG8_SB(0, 1), cB + hstep, voffB); PG8_STAGE(PG8_SA(0, 1), cA + hstep, voffA);
        if (wr == 1) PG8_BAR;
        PG8_WAIT_V(4); PG8_BAR;
        PG8_STAGE(PG8_SB(1, 0), cB + kstep, voffB); PG8_STAGE(PG8_SA(1, 0), cA + kstep, voffA); PG8_STAGE(PG8_SB(1, 1), cB + hstep + kstep, voffB);
        PG8_WAIT_V(6); PG8_BAR;
    }
    for (;;) {
        const bool has_next = S.next(ui + 1, nxt);
        const char* nA = has_next ? (const char*)g.A + (size_t)nxt.pm * tstep : cA; const char* nB = has_next ? (const char*)g.Bt + (size_t)nxt.pn * tstep : cB;
        for (int t = 0; t < nt; t += 2) {
            const bool last = (t == nt - 2);
            const char* a1 = cA + (size_t)(t + 1) * kstep;
            const char* a2 = last ? nA : cA + (size_t)(t + 2) * kstep; const char* b2 = last ? nB : cB + (size_t)(t + 2) * kstep;
            const char* a3 = a2 + kstep; const char* b3 = b2 + kstep;
            if (last && has_next) S.a_ready(nxt);
            if constexpr (SP2) {
            PG8_LDB(B0, 0, 0); PG8_LDB(B1, 0, 1); PG8_SCHED; PG8_LDA(At, 0, 0); PG8_STAGE(PG8_SA(1, 1), a1 + hstep, voffA);
            PG8_WAIT_V(8); PG8_WAIT_L(0); PG8_BAR; PG8_MMA(0, 0, At, B0); PG8_MMA(0, 1, At, B1); PG8_BAR; PG8_SCHED;
            PG8_LDA(At, 0, 1); PG8_STAGE(PG8_SB(0, 0), b2, voffB); PG8_STAGE(PG8_SB(0, 1), b2 + hstep, voffB); PG8_STAGE(PG8_SA(0, 0), a2, voffA);
            PG8_WAIT_V(8); PG8_WAIT_L(0); PG8_BAR; PG8_MMA(1, 0, At, B0); PG8_MMA(1, 1, At, B1); PG8_BAR; PG8_SCHED;
            PG8_LDB(B0, 1, 0); PG8_LDB(B1, 1, 1); PG8_SCHED; PG8_LDA(At, 1, 0); PG8_STAGE(PG8_SA(0, 1), a2 + hstep, voffA);
            PG8_WAIT_V(8); PG8_WAIT_L(0); PG8_BAR; PG8_MMA(0, 0, At, B0); PG8_MMA(0, 1, At, B1); PG8_BAR; PG8_SCHED;
            PG8_LDA(At, 1, 1); PG8_STAGE(PG8_SB(1, 0), b3, voffB); PG8_STAGE(PG8_SB(1, 1), b3 + hstep, voffB); PG8_STAGE(PG8_SA(1, 0), a3, voffA);
            PG8_WAIT_V(8); PG8_WAIT_L(0); PG8_BAR; PG8_MMA(1, 0, At, B0); PG8_MMA(1, 1, At, B1); PG8_BAR; PG8_SCHED;
            } else {
            PG8_LDB(B0, 0, 0); PG8_SCHED; PG8_LDA(At, 0, 0); PG8_STAGE(PG8_SA(1, 1), a1 + hstep, voffA);
            PG8_WAIT_L(8); PG8_BAR; PG8_WAIT_L(0); PG8_MMA(0, 0, At, B0); PG8_BAR; PG8_SCHED;
            PG8_LDB(B1, 0, 1); PG8_STAGE(PG8_SB(0, 0), b2, voffB);
            PG8_BAR; PG8_WAIT_L(0); PG8_MMA(0, 1, At, B1); PG8_BAR;
            PG8_LDA(At, 0, 1); PG8_STAGE(PG8_SA(0, 0), a2, voffA);
            PG8_BAR; PG8_WAIT_L(0); PG8_MMA(1, 0, At, B0); PG8_BAR; PG8_SCHED;
            PG8_STAGE(PG8_SB(0, 1), b2 + hstep, voffB);
            PG8_WAIT_V(6); PG8_BAR; PG8_MMA(1, 1, At, B1); PG8_BAR;
            PG8_LDB(B0, 1, 0); PG8_SCHED; PG8_LDA(At, 1, 0); PG8_STAGE(PG8_SA(0, 1), a2 + hstep, voffA);
            PG8_WAIT_L(8); PG8_BAR; PG8_WAIT_L(0); PG8_MMA(0, 0, At, B0); PG8_BAR; PG8_SCHED;
            PG8_LDB(B1, 1, 1); PG8_STAGE(PG8_SB(1, 0), b3, voffB);
            PG8_BAR; PG8_WAIT_L(0); PG8_MMA(0, 1, At, B1); PG8_BAR;
            PG8_LDA(At, 1, 1); PG8_STAGE(PG8_SA(1, 0), a3, voffA);
            PG8_BAR; PG8_WAIT_L(0); PG8_MMA(1, 0, At, B0); PG8_BAR; PG8_SCHED;
            PG8_STAGE(PG8_SB(1, 1), b3 + hstep, voffB);
            PG8_WAIT_V(6); PG8_BAR; PG8_MMA(1, 1, At, B1); PG8_BAR;
            }
        }
        if constexpr (ALIGN_EPI) { if (wr == 0) PG8_BAR; }
        if constexpr (!Epi::AFTER_DRAIN) { E(acc, cur, wr, wc, fr, fq); S.done(cur); }
        if (!has_next) break;
#pragma unroll
        for (int a = 0; a < 2; ++a)
#pragma unroll
            for (int b = 0; b < 2; ++b)
#pragma unroll
                for (int m = 0; m < 4; ++m)
#pragma unroll
                    for (int n = 0; n < 2; ++n) acc[a][b][m][n] = (f32x4){0.f, 0.f, 0.f, 0.f};
        cur = nxt; cA = nA; cB = nB; ++ui;
        if constexpr (ALIGN_EPI) { if (wr == 1) PG8_BAR; }
    }
    PG8_WAIT_V(0);
    if constexpr (!ALIGN_EPI) { if (wr == 0) PG8_BAR; }
    PG8_BAR;
    if constexpr (Epi::AFTER_DRAIN) { E.fused(acc, cur, wr, wc, fr, fq, lds, wid, lane); S.done(cur); }
#undef PG8_SA
#undef PG8_SB
#undef PG8_STAGE
#undef PG8_LDA
#undef PG8_LDB
#undef PG8_MMA
#undef PG8_WAIT_V
#undef PG8_WAIT_L
#undef PG8_BAR
#undef PG8_SCHED
}
}

#define LAS __attribute__((address_space(3)))
typedef unsigned short bf16;
typedef unsigned v4u __attribute__((ext_vector_type(4)));
typedef unsigned v2u __attribute__((ext_vector_type(2)));
typedef float f32x4 __attribute__((ext_vector_type(4)));
typedef short bf16x8 __attribute__((ext_vector_type(8)));
typedef short s16x4 __attribute__((ext_vector_type(4)));
constexpr int NWAVES = 8, NTHR = 512;
constexpr int DM = 1024, MP = 16384, MS = 1024, MTOT = MP + MS, DFF = 2816, NFF = 2 * DFF, DSGU = 3072, NSGU = 2 * DSGU, NCONV = 3072, DEPTH = 4;
constexpr float ALPHA = 1.6817928305074290f, LN_EPS = 1e-5f;
constexpr int PH_PER_LAYER = 11, NPHASE = DEPTH * PH_PER_LAYER;
constexpr size_t O_Y = 0, O_SCP = (size_t)MTOT * DM, O_SCS = O_SCP + 2 * 8 * 2 * 1024, O_SGV = O_SCS + 2 * 128 * 2 * 1024, O_END = O_SGV + (size_t)2 * 128 * 8 * 3072;
constexpr size_t MiB = 1u << 20;
constexpr size_t WS_STATS = 1 * MiB, WS_WB = 2 * MiB, WS_XB = 54 * MiB, WS_R = 88 * MiB, WS_END = 292 * MiB;
constexpr size_t W_F1IN = 0, W_F1OUT = W_F1IN + (size_t)NFF * DM, W_F2IN = W_F1OUT + (size_t)DM * DFF, W_F2OUT = W_F2IN + (size_t)NFF * DM, W_MIN = W_F2OUT + (size_t)DM * DFF, W_MOUT = W_MIN + (size_t)NSGU * DM, W_ENDE = W_MOUT + (size_t)DM * DSGU;
static_assert(WS_WB + W_ENDE * 2 <= WS_XB && WS_XB + (size_t)MTOT * DM * 2 <= WS_R, "ws map");
static_assert(WS_R + (size_t)2 * MTOT * DSGU * 2 <= WS_END, "ws map");
constexpr int LDS_BYTES = 147456;

__device__ __forceinline__ unsigned f2bf(float f) { unsigned u = __builtin_bit_cast(unsigned, f); return (u + 0x7fffu + ((u >> 16) & 1u)) >> 16; }
__device__ __forceinline__ unsigned pk2(float lo, float hi) { return f2bf(lo) | (f2bf(hi) << 16); }
__device__ __forceinline__ float bflo(unsigned w) { return __uint_as_float(w << 16); }
__device__ __forceinline__ float bfhi(unsigned w) { return __uint_as_float(w & 0xffff0000u); }
__device__ __forceinline__ float wave_sum(float v) {
#pragma unroll
    for (int o = 1; o < 64; o <<= 1) v += __shfl_xor(v, o);
    return v;
}
#define LDS_WAIT() asm volatile("s_waitcnt lgkmcnt(0)" ::: "memory")

struct Args { const float* in[18]; float* out; unsigned char* ws; int ph_lo, ph_hi, coop, pad; };

__device__ __forceinline__ void transpose_item(const float* W, int K, int N, bf16* WT, int kb, int n0, int c0, LAS float* scr, int lane) {
    const int k0 = 64 * kb;
#pragma unroll 8
    for (int i = 0; i < 32; ++i) { const int kk = 2 * i + (lane >> 5); scr[kk * 33 + (lane & 31)] = W[(size_t)(k0 + kk) * N + c0 + (lane & 31)]; }
    LDS_WAIT(); asm volatile("" ::: "memory");
    const int c = lane & 7;
#pragma unroll
    for (int j = 0; j < 4; ++j) { const int n = (lane >> 3) + 8 * j; const LAS float* s = scr + (8 * c) * 33 + n;
        v4u o; o.x = pk2(s[0 * 33], s[1 * 33]); o.y = pk2(s[2 * 33], s[3 * 33]); o.z = pk2(s[4 * 33], s[5 * 33]); o.w = pk2(s[6 * 33], s[7 * 33]);
        *(v4u*)(WT + (size_t)(n0 + n) * K + k0 + 8 * c) = o; }
    LDS_WAIT(); asm volatile("" ::: "memory");
}
__device__ __forceinline__ int src_col(int kind, int R) {
    if (kind == 1) return ((R >> 7) & 1) * DFF + (R >> 8) * 128 + (R & 127);
    if (kind == 2) return R < 2048 ? 1024 + ((R >> 7) & 1) * 1024 + (R >> 8) * 128 + (R & 127) : R - 2048;
    return R;
}
__device__ __forceinline__ bool convert_matrix(int& r, const float* W, int K, int N, int kind, bf16* WT, LAS float* scr, int lane) {
    const int nblk = N / 32, items = (K / 64) * nblk;
    if (r < items) { const int kb = r / nblk, n0 = 32 * (r % nblk); transpose_item(W, K, N, WT, kb, n0, src_col(kind, n0), scr, lane); return true; }
    r -= items; return false;
}

__device__ __forceinline__ void prep_phase(const Args& a, int layer, LAS unsigned char* lds, int bid, int G) {
    int tid_ = threadIdx.x; asm volatile("" : "+v"(tid_)); const int tid = tid_, lane = tid & 63, wave = __builtin_amdgcn_readfirstlane(tid >> 6);
    LAS float* scr = (LAS float*)(lds + wave * 16384);
    const int gw = bid * NWAVES + wave, NGW = G * NWAVES;
    bf16* WB = (bf16*)(a.ws + WS_WB);
    const bool sgu = layer & 1; const int j = layer >> 1;
    const int total = 2 * (16 * (NFF / 32) + (DFF / 64) * 32) + (sgu ? 16 * (NSGU / 32) + (DSGU / 64) * 32 : 16 * (NCONV / 32) + 16 * 32);
    for (int it = gw; it < total; it += NGW) {
        int r = it;
        if (convert_matrix(r, a.in[5] + (size_t)layer * DM * NFF, DM, NFF, 1, WB + W_F1IN, scr, lane)) continue;
        if (convert_matrix(r, a.in[6] + (size_t)layer * DFF * DM, DFF, DM, 0, WB + W_F1OUT, scr, lane)) continue;
        if (convert_matrix(r, a.in[7] + (size_t)layer * DM * NFF, DM, NFF, 1, WB + W_F2IN, scr, lane)) continue;
        if (convert_matrix(r, a.in[8] + (size_t)layer * DFF * DM, DFF, DM, 0, WB + W_F2OUT, scr, lane)) continue;
        if (sgu) {
            if (convert_matrix(r, a.in[12] + (size_t)j * DM * NSGU, DM, NSGU, 0, WB + W_MIN, scr, lane)) continue;
            convert_matrix(r, a.in[17] + (size_t)j * DSGU * DM, DSGU, DM, 0, WB + W_MOUT, scr, lane);
        } else {
            if (convert_matrix(r, a.in[9] + (size_t)j * DM * NCONV, DM, NCONV, 2, WB + W_MIN, scr, lane)) continue;
            convert_matrix(r, a.in[11] + (size_t)j * DM * DM, DM, DM, 0, WB + W_MOUT, scr, lane);
        }
    }
    { float* st = (float*)(a.ws + WS_STATS); for (int i = bid * NTHR + tid; i < 2 * MTOT; i += G * NTHR) st[i] = 0.f; }
    if (layer == 0) {
        float* X = a.out + O_Y; bf16* XB = (bf16*)(a.ws + WS_XB);
        const size_t n4 = (size_t)MTOT * DM / 4, np4 = (size_t)MP * DM / 4;
        for (size_t i = (size_t)bid * NTHR + tid; i < n4; i += (size_t)G * NTHR) {
            const f32x4 v = i < np4 ? ((const f32x4*)a.in[0])[i] : ((const f32x4*)a.in[1])[i - np4];
            ((f32x4*)X)[i] = v; v2u o; o.x = pk2(v.x, v.y); o.y = pk2(v.z, v.w); ((v2u*)XB)[i] = o; }
    }
}
__device__ __forceinline__ void ln_phase(const Args& a, const float* g, const float* b, int bid, int G) {
    int tid_ = threadIdx.x; asm volatile("" : "+v"(tid_)); const int tid = tid_, lane = tid & 63, wave = tid >> 6;
    float* X = a.out + O_Y; bf16* XB = (bf16*)(a.ws + WS_XB);
    f32x4 gv[4], bv[4];
#pragma unroll
    for (int jj = 0; jj < 4; ++jj) { gv[jj] = ((const f32x4*)g)[lane + 64 * jj]; bv[jj] = ((const f32x4*)b)[lane + 64 * jj]; }
    for (int m = bid * NWAVES + wave; m < MTOT; m += G * NWAVES) {
        f32x4* xr = (f32x4*)(X + (size_t)m * DM) + lane;
        f32x4 v[4]; float s = 0.f;
#pragma unroll
        for (int jj = 0; jj < 4; ++jj) { v[jj] = xr[64 * jj]; s += (v[jj].x + v[jj].y) + (v[jj].z + v[jj].w); }
        const float mean = wave_sum(s) * (1.f / DM); float s2 = 0.f;
#pragma unroll
        for (int jj = 0; jj < 4; ++jj) { v[jj] = v[jj] - mean; s2 += (v[jj].x * v[jj].x + v[jj].y * v[jj].y) + (v[jj].z * v[jj].z + v[jj].w * v[jj].w); }
        const float rstd = 1.f / sqrtf(wave_sum(s2) * (1.f / DM) + LN_EPS);
        v2u* o8 = (v2u*)(XB + (size_t)m * DM) + lane;
#pragma unroll
        for (int jj = 0; jj < 4; ++jj) { const f32x4 o = v[jj] * rstd * gv[jj] + bv[jj]; xr[64 * jj] = o; v2u w; w.x = pk2(o.x, o.y); w.y = pk2(o.z, o.w); o8[64 * jj] = w; }
    }
}
__device__ __forceinline__ void conv_phase(const Args& a, int j, int bid, int G) {
    const bf16* G0 = (const bf16*)(a.ws + WS_R); const bf16* Bg = G0 + (size_t)MTOT * DM; bf16* Gc = (bf16*)Bg + (size_t)MTOT * DM;
    const float* cw = a.in[10] + (size_t)j * 3 * DM; const float* cache = a.in[2] + (size_t)j * 128 * 2 * DM;
    int tid_ = threadIdx.x; asm volatile("" : "+v"(tid_)); const int tid = tid_;
    const int cg8 = tid & 127;
    float w0[8], w1[8], w2[8];
#pragma unroll
    for (int e = 0; e < 8; ++e) { w0[e] = cw[cg8 * 8 + e]; w1[e] = cw[DM + cg8 * 8 + e]; w2[e] = cw[2 * DM + cg8 * 8 + e]; }
    for (int row = bid * 4 + (tid >> 7); row < MTOT; row += G * 4) {
        int t; const float* cb = nullptr;
        if (row < MP) t = row & 2047; else { const int rs = row - MP; t = rs & 7; cb = cache + (size_t)(rs >> 3) * 2 * DM + cg8 * 8; }
        float gm2[8], gm1[8], g0[8];
        const size_t off = (size_t)row * DM + cg8 * 8;
        { const v4u q = *(const v4u*)(G0 + off); g0[0] = bflo(q.x); g0[1] = bfhi(q.x); g0[2] = bflo(q.y); g0[3] = bfhi(q.y); g0[4] = bflo(q.z); g0[5] = bfhi(q.z); g0[6] = bflo(q.w); g0[7] = bfhi(q.w); }
        if (t >= 1) { const v4u q = *(const v4u*)(G0 + off - DM); gm1[0] = bflo(q.x); gm1[1] = bfhi(q.x); gm1[2] = bflo(q.y); gm1[3] = bfhi(q.y); gm1[4] = bflo(q.z); gm1[5] = bfhi(q.z); gm1[6] = bflo(q.w); gm1[7] = bfhi(q.w); }
        else {
#pragma unroll
            for (int e = 0; e < 8; ++e) gm1[e] = cb ? cb[DM + e] : 0.f; }
        if (t >= 2) { const v4u q = *(const v4u*)(G0 + off - 2 * DM); gm2[0] = bflo(q.x); gm2[1] = bfhi(q.x); gm2[2] = bflo(q.y); gm2[3] = bfhi(q.y); gm2[4] = bflo(q.z); gm2[5] = bfhi(q.z); gm2[6] = bflo(q.w); gm2[7] = bfhi(q.w); }
        else {
#pragma unroll
            for (int e = 0; e < 8; ++e) gm2[e] = cb ? cb[t * DM + e] : 0.f; }
        const v4u bq = *(const v4u*)(Bg + off);
        const float bb[8] = {bflo(bq.x), bfhi(bq.x), bflo(bq.y), bfhi(bq.y), bflo(bq.z), bfhi(bq.z), bflo(bq.w), bfhi(bq.w)};
        float o[8];
#pragma unroll
        for (int e = 0; e < 8; ++e) o[e] = bb[e] * (w0[e] * gm2[e] + w1[e] * gm1[e] + w2[e] * g0[e]);
        v4u w; w.x = pk2(o[0], o[1]); w.y = pk2(o[2], o[3]); w.z = pk2(o[4], o[5]); w.w = pk2(o[6], o[7]);
        *(v4u*)(Gc + off) = w;
    }
}
constexpr int VS = 784, WPS = 272, MIX_VT = 0, MIX_WP = 128 * VS, MIX_RC = MIX_WP + 128 * WPS;
static_assert(MIX_RC + 5 * 512 <= LDS_BYTES, "mix LDS");
__device__ __forceinline__ s16x4 vtr(const LAS unsigned char* p) { return __builtin_bit_cast(s16x4, __builtin_amdgcn_ds_read_tr16_b64_v4i16((LAS s16x4*)p)); }
__device__ __forceinline__ void mix_phase(const Args& a, int j, LAS unsigned char* lds, int bid, int G) {
    bf16* U = (bf16*)(a.ws + WS_R); const bf16* V = U + (size_t)MTOT * DSGU; const float* stats = (const float*)(a.ws + WS_STATS);
    const float* Ws = a.in[15] + (size_t)j * 8 * 128 * 128; const float* Bs = a.in[16] + (size_t)j * 8 * 128;
    const float* lg = a.in[13] + (size_t)j * DSGU; const float* lb = a.in[14] + (size_t)j * DSGU;
    float* sgv = a.out + O_SGV + (size_t)j * 128 * 8 * DSGU;
    int tid_ = threadIdx.x; asm volatile("" : "+v"(tid_)); const int tid = tid_, lane = tid & 63, wave = __builtin_amdgcn_readfirstlane(tid >> 6);
    LAS float* mu = (LAS float*)(lds + MIX_RC); LAS float* rs = mu + 128; LAS float* at = rs + 128; LAS float* wt = at + 128; LAS float* bt = wt + 128;
    for (int unit = bid; unit < 136 * 8; unit += G) {
        const int ck = unit >> 3, h = unit & 7, r0 = ck * 128, c0 = h * 384; const bool samp = ck >= 128;
        __syncthreads();
#pragma unroll 6
        for (int i = 0; i < 12; ++i) { const int idx = tid + NTHR * i, r = idx / 48, ch = idx % 48;
            const v4u q = *(const v4u*)(V + (size_t)(r0 + r) * DSGU + c0 + 8 * ch); *(LAS v4u*)(lds + MIX_VT + r * VS + 16 * ch) = q; }
        if (tid < 128) { const float s1 = stats[2 * (r0 + tid)], s2 = stats[2 * (r0 + tid) + 1]; const float m = s1 * (1.f / DSGU); const float var = fmaxf(s2 * (1.f / DSGU) - m * m, 0.f);
            mu[tid] = m; rs[tid] = 1.f / sqrtf(var + LN_EPS); }
        __syncthreads();
        { const int t = tid >> 2, qd = tid & 3; float asum = 0.f, wsum = 0.f;
            const float* wrow = Ws + (size_t)h * 16384 + (samp ? (t & 7) * 128 : t * 128);
#pragma unroll 1
            for (int s8 = 0; s8 < 4; ++s8) { float wv[8];
#pragma unroll
                for (int e = 0; e < 8; ++e) { const int s = 32 * qd + 8 * s8 + e;
                    if (samp) wv[e] = ((s >> 3) == (t >> 3) && (s & 7) <= (t & 7)) ? wrow[s & 7] : 0.f;
                    else wv[e] = s <= t ? wrow[s] : 0.f; }
                unsigned pw[4];
#pragma unroll
                for (int e = 0; e < 4; ++e) { const int s = 32 * qd + 8 * s8 + 2 * e; pw[e] = pk2(wv[2 * e] * rs[s], wv[2 * e + 1] * rs[s + 1]);
                    asum += bflo(pw[e]) * mu[s] + bfhi(pw[e]) * mu[s + 1]; wsum += wv[2 * e] + wv[2 * e + 1]; }
                *(LAS v4u*)(lds + MIX_WP + t * WPS + (32 * qd + 8 * s8) * 2) = (v4u){pw[0], pw[1], pw[2], pw[3]}; }
            asum += __shfl_xor(asum, 1); asum += __shfl_xor(asum, 2); wsum += __shfl_xor(wsum, 1); wsum += __shfl_xor(wsum, 2);
            if (qd == 0) { at[t] = asum; wt[t] = wsum; bt[t] = Bs[h * 128 + (samp ? (t & 7) : t)]; } }
        __syncthreads();
        const int g = lane >> 4, li = lane & 15, q = li >> 2, p = li & 3, cb = 48 * wave;
        f32x4 acc[3][8];
#pragma unroll
        for (int ci = 0; ci < 3; ++ci)
#pragma unroll
            for (int tt = 0; tt < 8; ++tt) acc[ci][tt] = (f32x4){0.f, 0.f, 0.f, 0.f};
#pragma unroll
        for (int ks = 0; ks < 4; ++ks) {
            bf16x8 vf[3];
#pragma unroll
            for (int ci = 0; ci < 3; ++ci) { const LAS unsigned char* ap = lds + MIX_VT + (32 * ks + 8 * g + q) * VS + (cb + 16 * ci + 4 * p) * 2;
                const s16x4 lo = vtr(ap), hi = vtr(ap + 4 * VS); vf[ci] = (bf16x8){lo[0], lo[1], lo[2], lo[3], hi[0], hi[1], hi[2], hi[3]}; }
#pragma unroll
            for (int tt = 2 * ks; tt < 8; ++tt) {
                const bf16x8 wf = *(const LAS bf16x8*)(lds + MIX_WP + (16 * tt + li) * WPS + (32 * ks + 8 * g) * 2);
#pragma unroll
                for (int ci = 0; ci < 3; ++ci) acc[ci][tt] = __builtin_amdgcn_mfma_f32_16x16x32_bf16(vf[ci], wf, acc[ci][tt], 0, 0, 0);
                if ((tt & 1) == 1) __builtin_amdgcn_sched_barrier(0);
            }
            __builtin_amdgcn_sched_barrier(0);
        }
#pragma unroll
        for (int ci = 0; ci < 3; ++ci) { const int cc = c0 + cb + 16 * ci + 4 * g; const f32x4 gam = *(const f32x4*)(lg + cc), bet = *(const f32x4*)(lb + cc);
#pragma unroll
            for (int tt = 0; tt < 8; ++tt) { const int t = 16 * tt + li; const float av = at[t], wv = wt[t], bv = bt[t];
                bf16* up = U + (size_t)(r0 + t) * DSGU + cc; const v2u uq = *(const v2u*)up;
                const f32x4 mix = gam * (acc[ci][tt] - av) + bet * wv + bv;
                v2u o; o.x = pk2(bflo(uq.x) * mix[0], bfhi(uq.x) * mix[1]); o.y = pk2(bflo(uq.y) * mix[2], bfhi(uq.y) * mix[3]); *(v2u*)up = o;
                if ((tt & 3) == 3) __builtin_amdgcn_sched_barrier(0); } }
        if (samp) {
#pragma unroll 1
            for (int i = 0; i < 12; ++i) { const int idx = tid + NTHR * i, r = idx / 48, ch = idx % 48;
                const v4u qv = *(const LAS v4u*)(lds + MIX_VT + r * VS + 16 * ch); const float m = mu[r], rr = rs[r];
                const f32x4 g0 = *(const f32x4*)(lg + c0 + 8 * ch), g1 = *(const f32x4*)(lg + c0 + 8 * ch + 4), b0 = *(const f32x4*)(lb + c0 + 8 * ch), b1 = *(const f32x4*)(lb + c0 + 8 * ch + 4);
                const f32x4 x0 = {bflo(qv.x), bfhi(qv.x), bflo(qv.y), bfhi(qv.y)}, x1 = {bflo(qv.z), bfhi(qv.z), bflo(qv.w), bfhi(qv.w)};
                float* dst = sgv + (size_t)((ck - 128) * 128 + r) * DSGU + c0 + 8 * ch;
                *(f32x4*)dst = (x0 - m) * rr * g0 + b0; *(f32x4*)(dst + 4) = (x1 - m) * rr * g1 + b1; }
        }
    }
}

__global__ void __launch_bounds__(NTHR, 2) fwd_kernel(Args a) {
    extern __shared__ __attribute__((aligned(16))) unsigned char lds_raw[];
    LAS unsigned char* lds = (LAS unsigned char*)lds_raw;
    const int bid = blockIdx.x, G = gridDim.x;
    bf16* WB = (bf16*)(a.ws + WS_WB); bf16* XB = (bf16*)(a.ws + WS_XB); bf16* R = (bf16*)(a.ws + WS_R);
    float* X = a.out + O_Y;
    for (int ph = a.ph_lo; ph < a.ph_hi; ++ph) {
        const int layer = ph / PH_PER_LAYER, k = ph % PH_PER_LAYER, j = layer >> 1; const bool sgu = layer & 1;
        if (k == 0) prep_phase(a, layer, lds, bid, G);
        else if (k == 1 || k == 8) {
            pg8::Gemm g{XB, WB + (k == 1 ? W_F1IN : W_F2IN), MTOT, NFF, DM}; pg8::StaticOrder S; S.init(MTOT, NFF, G, bid);
            pg8::EpiSwiGLU E{R, DFF};
            pg8::gemm_phase<pg8::EpiSwiGLU, pg8::StaticOrder, true, true>(lds, g, S, E);
        } else if (k == 2 || k == 9) {
            pg8::Gemm g{R, WB + (k == 2 ? W_F1OUT : W_F2OUT), MTOT, DM, DFF}; pg8::StaticOrder S; S.init(MTOT, DM, G, bid);
            pg8::EpiResid E{X, DM, ALPHA, 0.5f};
            pg8::gemm_phase<pg8::EpiResid, pg8::StaticOrder, true, true>(lds, g, S, E);
        } else if (k == 3 || k == 7 || k == 10) {
            const int w = k == 3 ? 0 : (k == 7 ? 1 : 2);
            ln_phase(a, a.in[3] + (size_t)(layer * 3 + w) * DM, a.in[4] + (size_t)(layer * 3 + w) * DM, bid, G);
        } else if (k == 4) {
            if (sgu) { pg8::Gemm g{XB, WB + W_MIN, MTOT, NSGU, DM}; pg8::StaticOrder S; S.init(MTOT, NSGU, G, bid);
                pg8::EpiSguIn E{R, R + (size_t)MTOT * DSGU, (float*)(a.ws + WS_STATS)};
                pg8::gemm_phase<pg8::EpiSguIn, pg8::StaticOrder, true, true>(lds, g, S, E);
            } else { pg8::Gemm g{XB, WB + W_MIN, MTOT, NCONV, DM}; pg8::StaticOrder S; S.init(MTOT, NCONV, G, bid);
                pg8::EpiConvIn E{R, R + (size_t)MTOT * DM, a.out + O_SCP + (size_t)j * 8 * 2 * 1024, a.out + O_SCS + (size_t)j * 128 * 2 * 1024};
                pg8::gemm_phase<pg8::EpiConvIn, pg8::StaticOrder, true, true>(lds, g, S, E);
            }
        } else if (k == 5) {
            if (sgu) mix_phase(a, j, lds, bid, G); else conv_phase(a, j, bid, G);
        } else if (k == 6) {
            const int K = sgu ? DSGU : DM; const bf16* A = sgu ? R : R + (size_t)2 * MTOT * DM;
            pg8::Gemm g{A, WB + W_MOUT, MTOT, DM, K}; pg8::StaticOrder S; S.init(MTOT, DM, G, bid);
            pg8::EpiResid E{X, DM, ALPHA, 1.0f};
            pg8::gemm_phase<pg8::EpiResid, pg8::StaticOrder, true, true>(lds, g, S, E);
        }
        if (ph + 1 < a.ph_hi) { if (a.coop) cg::this_grid().sync(); }
    }
}

#ifndef N_LAUNCH_MODE
#define N_LAUNCH_MODE 0
#endif
extern "C" void kernel_launch(void* const* d_in, const int* in_sizes, int n_in, void* d_out, int out_size, void* d_ws, size_t ws_size, hipStream_t stream) {
    static int grid = 0;
    if (grid == 0) {
        int dev = 0, cus = 0, per_cu = 0;
        if (n_in != 18 || (size_t)out_size != O_END || ws_size < WS_END) { fprintf(stderr, "kernel_launch: unexpected shapes (n_in %d out %d ws %zu)\n", n_in, out_size, ws_size); grid = -1; return; }
        hipGetDevice(&dev); hipDeviceGetAttribute(&cus, hipDeviceAttributeMultiprocessorCount, dev);
        if (hipFuncSetAttribute((const void*)fwd_kernel, hipFuncAttributeMaxDynamicSharedMemorySize, LDS_BYTES) != hipSuccess) { fprintf(stderr, "kernel_launch: hipFuncSetAttribute failed\n"); grid = -1; return; }
        hipOccupancyMaxActiveBlocksPerMultiprocessor(&per_cu, (const void*)fwd_kernel, NTHR, LDS_BYTES);
        (void)hipGetLastError();
        if (per_cu < 1) per_cu = 1;
        grid = cus * 1;
        fprintf(stderr, "kernel_launch: cus %d per_cu %d grid %d ws %zu\n", cus, per_cu, grid, ws_size);
    }
    if (grid < 0) return;
    Args a{};
    for (int i = 0; i < 18; ++i) a.in[i] = (const float*)d_in[i];
    a.out = (float*)d_out; a.ws = (unsigned char*)d_ws;
#if N_LAUNCH_MODE == 1
    a.ph_lo = 0; a.ph_hi = NPHASE; a.coop = 1;
    void* args[] = {&a};
    hipError_t e = hipLaunchCooperativeKernel((const void*)fwd_kernel, dim3(grid), dim3(NTHR), args, LDS_BYTES, stream);
    if (e != hipSuccess) fprintf(stderr, "cooperative launch failed: %s (grid %d)\n", hipGetErrorString(e), grid);
#else
    for (int ph = 0; ph < NPHASE; ++ph) { a.ph_lo = ph; a.ph_hi = ph + 1; a.coop = 0;
        hipLaunchKernelGGL(fwd_kernel, dim3(grid), dim3(NTHR), LDS_BYTES, stream, a); }
#endif
}
```
